# Optimizing an MI355X kernel written in HIP

```python
import jax, jax.numpy as jnp
from jax import lax
import numpy as np

D_MODEL = 1024
BATCH = 2
SEQ = 8192
DEPTH = 1

CHUNK = 64
D_MIX = D_MODEL
D_CONV = D_MIX // 2
CONV_WIDTH = 3
N_HEADS = 8
HEAD_DIM = (D_MIX - D_CONV) // N_HEADS
D_ATTN = N_HEADS * HEAD_DIM
ROT_DIM = HEAD_DIM // 4
ROPE_THETA = 500000.0
IDX_HEADS = 4
IDX_DIM = 64
IDX_ROT_DIM = IDX_DIM // 4
INDEX_TOPK = 256
Q_BLOCK = 128
EPS = 1e-6

SPLIT_SIZES = (
    D_CONV, D_CONV, D_CONV, D_CONV,
    D_ATTN, D_ATTN, D_ATTN, D_ATTN,
    IDX_HEADS * IDX_DIM, IDX_DIM, IDX_HEADS,
)
PROJ_DIM = sum(SPLIT_SIZES)

kernel_name = "hybrid_shortconv_dsa_sandwich"


def rms_norm(x, g):
    xf = x.astype(jnp.float32)
    xf = xf * lax.rsqrt(jnp.mean(xf * xf, axis=-1, keepdims=True) + EPS)
    return (xf * g.astype(jnp.float32)).astype(x.dtype)


def rope_partial(x, pos, rot_dim):
    half = rot_dim // 2
    inv_freq = jnp.power(jnp.float32(ROPE_THETA), -jnp.arange(half, dtype=jnp.float32) / half)
    ang = pos.astype(jnp.float32)[:, None] * inv_freq[None, :]
    cos = jnp.cos(ang)[None, :, None, :]
    sin = jnp.sin(ang)[None, :, None, :]
    xr = x[..., :rot_dim].astype(jnp.float32)
    x1, x2 = xr[..., :half], xr[..., half:]
    rot = jnp.concatenate([x1 * cos - x2 * sin, x2 * cos + x1 * sin], axis=-1).astype(x.dtype)
    return jnp.concatenate([rot, x[..., rot_dim:]], axis=-1)


def short_conv_mixer(h, b_gate, c_gate, conv_w):
    u = c_gate * h
    rhs = conv_w.reshape(CONV_WIDTH, 1, D_CONV).astype(u.dtype)
    y = lax.conv_general_dilated(
        u, rhs, window_strides=(1,), padding=[(CONV_WIDTH - 1, 0)],
        dimension_numbers=("NWC", "WIO", "NWC"), feature_group_count=D_CONV)
    return b_gate * y


def sparse_indexed_attention(q, k, v, q_idx, k_idx, w_idx, pos, top_k):
    B, S, H, Dh = q.shape
    nblk = S // Q_BLOCK

    def to_blocks(a):
        return jnp.moveaxis(a.reshape((B, nblk, Q_BLOCK) + a.shape[2:]), 1, 0)

    def block_fn(args):
        qb, qib, wb, posb = args
        limit = (posb // CHUNK + 1) * CHUNK
        admissible = pos[None, :] < limit[:, None]
        logits = jnp.einsum("bqhd,bsd->bqhs", qib, k_idx,
                            preferred_element_type=jnp.float32) * (IDX_DIM ** -0.5)
        score = jnp.einsum("bqh,bqhs->bqs", wb.astype(jnp.float32) * (IDX_HEADS ** -0.5),
                           jax.nn.relu(logits))
        score = jnp.where(admissible[None], score, -jnp.inf)
        _, sel = lax.top_k(score, top_k)
        valid = sel < limit[None, :, None]
        kg = jax.vmap(lambda kk, ii: kk[ii])(k, sel)
        vg = jax.vmap(lambda vv, ii: vv[ii])(v, sel)
        att = jnp.einsum("bqhd,bqkhd->bqhk", qb, kg,
                         preferred_element_type=jnp.float32) * (HEAD_DIM ** -0.5)
        att = jnp.where(valid[:, :, None, :], att, -jnp.inf)
        p = jax.nn.softmax(att, axis=-1)
        return jnp.einsum("bqhk,bqkhd->bqhd", p.astype(vg.dtype), vg)

    out = lax.map(block_fn, (to_blocks(q), to_blocks(q_idx), to_blocks(w_idx),
                             pos.reshape(nblk, Q_BLOCK)))
    return jnp.moveaxis(out, 0, 1).reshape(B, S, H, Dh)


def setup_inputs(seed: int = 0) -> dict:
    key = jax.random.key(seed)
    ks = jax.random.split(key, 7)
    x = jax.random.normal(ks[0], (BATCH, SEQ, D_MODEL), jnp.float32)
    norm_pre_g = 1.0 + 0.05 * jax.random.normal(ks[1], (DEPTH, D_MODEL), jnp.float32)
    w_in = jax.random.normal(ks[2], (DEPTH, D_MODEL, PROJ_DIM), jnp.float32) * (D_MODEL ** -0.5)
    conv_w = jax.random.normal(ks[3], (DEPTH, CONV_WIDTH, D_CONV), jnp.float32) * (CONV_WIDTH ** -0.5)
    w_out = jax.random.normal(ks[4], (DEPTH, D_MIX, D_MODEL), jnp.float32) * (D_MIX ** -0.5)
    norm_post_g = 1.0 + 0.05 * jax.random.normal(ks[5], (DEPTH, D_MODEL), jnp.float32)
    return {"x": x, "norm_pre_g": norm_pre_g, "w_in": w_in, "conv_w": conv_w,
            "w_out": w_out, "norm_post_g": norm_post_g}


def reference(x, norm_pre_g, w_in, conv_w, w_out, norm_post_g):
    B, S, _ = x.shape
    top_k = min(INDEX_TOPK, S // 4)
    pos = jnp.arange(S, dtype=jnp.int32)
    split_idx = [int(i) for i in np.cumsum(SPLIT_SIZES)[:-1]]
    for l in range(DEPTH):
        xn = rms_norm(x, norm_pre_g[l])
        proj = jnp.einsum("bsd,dp->bsp", xn, w_in[l])
        (h, b_gate, c_gate, z_conv, q, k, v, z_attn,
         q_idx, k_idx, w_idx) = jnp.split(proj, split_idx, axis=-1)

        y_conv = short_conv_mixer(h, b_gate, c_gate, conv_w[l]) * jax.nn.silu(z_conv)

        q = rope_partial(q.reshape(B, S, N_HEADS, HEAD_DIM), pos, ROT_DIM)
        k = rope_partial(k.reshape(B, S, N_HEADS, HEAD_DIM), pos, ROT_DIM)
        v = v.reshape(B, S, N_HEADS, HEAD_DIM)
        q_idx = rope_partial(q_idx.reshape(B, S, IDX_HEADS, IDX_DIM), pos, IDX_ROT_DIM)
        k_idx = rope_partial(k_idx[:, :, None, :], pos, IDX_ROT_DIM)[:, :, 0, :]
        o = sparse_indexed_attention(q, k, v, q_idx, k_idx, w_idx, pos, top_k)
        y_attn = o.reshape(B, S, D_ATTN) * jax.nn.silu(z_attn)

        y = jnp.einsum("bsm,md->bsd", jnp.concatenate([y_conv, y_attn], axis=-1), w_out[l])
        x = x + rms_norm(y, norm_post_g[l])
    return x
```

```cpp
#include <hip/hip_runtime.h>
#include <math.h>
#include <stdint.h>

constexpr int NB = 2, S = 8192, D = 1024, T = NB * S;
constexpr int PROJ = 4420;
constexpr int C_Q = 2048, C_K = 2560, C_V = 3072, C_ZA = 3584, C_QI = 4096, C_KI = 4352, C_W = 4416;
constexpr float EPS = 1e-6f;

struct Rope { float invf[8]; };

__device__ __forceinline__ float silu_f(float z) { return z / (1.0f + expf(-z)); }

__device__ __forceinline__ void sincos_acc(float a, float& s, float& c) {
    double x = (double)a;
    double k = rint(x * 0.63661977236758134308);
    double r = fma(-k, 1.57079632679489655800e+00, x);
    r = fma(-k, 6.12323399573676603587e-17, r);
    int q = ((int)k) & 3;
    double r2 = r * r;
    double sp = r * (1.0 + r2 * (-1.0 / 6 + r2 * (1.0 / 120 + r2 * (-1.0 / 5040 + r2 * (1.0 / 362880 + r2 * (-1.0 / 39916800 + r2 * (1.0 / 6227020800.0)))))));
    double cp = 1.0 + r2 * (-0.5 + r2 * (1.0 / 24 + r2 * (-1.0 / 720 + r2 * (1.0 / 40320 + r2 * (-1.0 / 3628800 + r2 * (1.0 / 479001600.0 + r2 * (-1.0 / 87178291200.0)))))));
    double ss, cc;
    if (q == 0) { ss = sp; cc = cp; } else if (q == 1) { ss = cp; cc = -sp; } else if (q == 2) { ss = -sp; cc = -cp; } else { ss = -cp; cc = sp; }
    s = (float)ss; c = (float)cc;
}

__global__ void __launch_bounds__(256) rms_kernel(const float* __restrict__ x, float* __restrict__ rs) {
    const int row = blockIdx.x * 4 + (threadIdx.x >> 6), lane = threadIdx.x & 63;
    const float4* p = (const float4*)(x + (size_t)row * D);
    float s = 0.f;
    for (int j = 0; j < 4; ++j) { float4 v = p[lane + 64 * j]; s += v.x * v.x + v.y * v.y + v.z * v.z + v.w * v.w; }
    for (int o = 1; o < 64; o <<= 1) s += __shfl_xor(s, o);
    if (lane == 0) rs[row] = 1.0f / sqrtf(s * (1.0f / D) + EPS);
}

__global__ void __launch_bounds__(256) gemm1_naive(const float* __restrict__ x, const float* __restrict__ rs, const float* __restrict__ g,
                                                   const float* __restrict__ w, float* U, float* G, float* Qb, float* Kb, float* Vb, float* Zb,
                                                   float* QI, float* KI, float* Wb) {
    __shared__ float As[16][68];
    __shared__ float Bs[16][68];
    const int tid = threadIdx.x, tx = tid & 15, ty = tid >> 4;
    const int n0 = blockIdx.x * 64, m0 = blockIdx.y * 64;
    float acc[4][4];
    for (int i = 0; i < 4; ++i) for (int j = 0; j < 4; ++j) acc[i][j] = 0.f;
    const int am = tid >> 2, ak = (tid & 3) * 4;
    const float ars = rs[m0 + am];
    const int bk = tid >> 4, bn = (tid & 15) * 4;
    int src[4];
    for (int j = 0; j < 4; ++j) { int v = n0 + bn + j; int s_ = (v < 2048) ? ((v & 3) * 512 + (v >> 2)) : v; src[j] = (v < PROJ) ? s_ : -1; }
    for (int k0 = 0; k0 < D; k0 += 16) {
        float4 a = *(const float4*)(x + (size_t)(m0 + am) * D + k0 + ak);
        float4 gg = *(const float4*)(g + k0 + ak);
        As[ak + 0][am] = a.x * ars * gg.x; As[ak + 1][am] = a.y * ars * gg.y; As[ak + 2][am] = a.z * ars * gg.z; As[ak + 3][am] = a.w * ars * gg.w;
        for (int j = 0; j < 4; ++j) Bs[bk][bn + j] = (src[j] >= 0) ? w[(size_t)(k0 + bk) * PROJ + src[j]] : 0.f;
        __syncthreads();
        for (int k = 0; k < 16; ++k) {
            float av[4], bv[4];
            for (int i = 0; i < 4; ++i) av[i] = As[k][ty * 4 + i];
            for (int j = 0; j < 4; ++j) bv[j] = Bs[k][tx * 4 + j];
            for (int i = 0; i < 4; ++i) for (int j = 0; j < 4; ++j) acc[i][j] = fmaf(av[i], bv[j], acc[i][j]);
        }
        __syncthreads();
    }
    if (n0 < 2048) {
        const int ch = (n0 + tx * 4) >> 2;
        for (int i = 0; i < 4; ++i) {
            const int m = m0 + ty * 4 + i;
            const float h = acc[i][0], b = acc[i][1], c = acc[i][2], z = acc[i][3];
            U[(size_t)m * 512 + ch] = c * h;
            G[(size_t)m * 512 + ch] = b * silu_f(z);
        }
    } else {
        for (int i = 0; i < 4; ++i) {
            const int m = m0 + ty * 4 + i;
            for (int j = 0; j < 4; ++j) {
                const int n = n0 + tx * 4 + j; const float v = acc[i][j];
                if (n >= PROJ) continue;
                if (n < C_K) Qb[(size_t)m * 512 + n - C_Q] = v;
                else if (n < C_V) Kb[(size_t)m * 512 + n - C_K] = v;
                else if (n < C_ZA) Vb[(size_t)m * 512 + n - C_V] = v;
                else if (n < C_QI) Zb[(size_t)m * 512 + n - C_ZA] = v;
                else if (n < C_KI) QI[(size_t)m * 256 + n - C_QI] = v;
                else if (n < C_W) KI[(size_t)m * 64 + n - C_KI] = v;
                else Wb[(size_t)m * 4 + n - C_W] = v;
            }
        }
    }
}

__global__ void __launch_bounds__(256) rope_kernel(float* Qb, float* Kb, float* QI, float* KI, Rope rp) {
    const int tok = blockIdx.x, tid = threadIdx.x;
    if (tid >= 168) return;
    const int hh = tid >> 3, j = tid & 7;
    float* p;
    if (hh < 8) p = Qb + (size_t)tok * 512 + hh * 64;
    else if (hh < 16) p = Kb + (size_t)tok * 512 + (hh - 8) * 64;
    else if (hh < 20) p = QI + (size_t)tok * 256 + (hh - 16) * 64;
    else p = KI + (size_t)tok * 64;
    const int pos = tok % S;
    const float ang = (float)pos * rp.invf[j];
    float sn, cs; sincos_acc(ang, sn, cs);
    const float x1 = p[j], x2 = p[j + 8];
    p[j] = x1 * cs - x2 * sn;
    p[j + 8] = x2 * cs + x1 * sn;
}

__global__ void __launch_bounds__(256) conv_kernel(const float* __restrict__ U, float* G, const float* __restrict__ cw) {
    const size_t idx = (size_t)blockIdx.x * 256 + threadIdx.x;
    const int ch = (int)(idx & 511); const int tok = (int)(idx >> 9); const int t = tok % S;
    float a = cw[2 * 512 + ch] * U[idx];
    if (t >= 1) a += cw[1 * 512 + ch] * U[idx - 512];
    if (t >= 2) a += cw[0 * 512 + ch] * U[idx - 1024];
    G[idx] = G[idx] * a;
}

__device__ __forceinline__ unsigned fkey(float f) { unsigned u = __float_as_uint(f); return (u & 0x80000000u) ? ~u : (u | 0x80000000u); }

__global__ void __launch_bounds__(256) attn_naive(const float* __restrict__ Qb, const float* __restrict__ Kb, const float* __restrict__ Vb, float* Zb,
                                                  const float* __restrict__ QI, const float* __restrict__ KI, const float* __restrict__ Wb) {
    __shared__ unsigned keys[8192];
    __shared__ float att[8 * 256];
    __shared__ float qi[256];
    __shared__ float qv[512];
    __shared__ float wv[4];
    __shared__ int hist[256];
    __shared__ int sel[256];
    __shared__ int cnt[256];
    __shared__ int sh_chosen, sh_need, sh_nsel;
    const int tok = blockIdx.x, tid = threadIdx.x;
    const int b = tok / S, t = tok % S;
    const int N = ((t >> 6) + 1) << 6;
    qi[tid] = QI[(size_t)tok * 256 + tid];
    qv[tid] = Qb[(size_t)tok * 512 + tid]; qv[tid + 256] = Qb[(size_t)tok * 512 + tid + 256];
    if (tid < 4) wv[tid] = Wb[(size_t)tok * 4 + tid] * 0.5f;
    if (tid == 0) sh_nsel = 0;
    __syncthreads();
#pragma unroll 1
    for (int s = tid; s < N; s += 256) {
        const float4* kp = (const float4*)(KI + (size_t)(b * S + s) * 64);
        float d[4] = {0.f, 0.f, 0.f, 0.f};
#pragma unroll 2
        for (int e = 0; e < 16; ++e) {
            const float4 kk = kp[e];
            for (int h = 0; h < 4; ++h) {
                d[h] = fmaf(qi[h * 64 + e * 4 + 0], kk.x, d[h]); d[h] = fmaf(qi[h * 64 + e * 4 + 1], kk.y, d[h]);
                d[h] = fmaf(qi[h * 64 + e * 4 + 2], kk.z, d[h]); d[h] = fmaf(qi[h * 64 + e * 4 + 3], kk.w, d[h]);
            }
        }
        float sc = 0.f;
        for (int h = 0; h < 4; ++h) sc += wv[h] * fmaxf(d[h] * 0.125f, 0.f);
        if (sc == 0.f) sc = 0.f;
        keys[s] = fkey(sc);
    }
    __syncthreads();
    int nsel;
    if (N <= 256) {
        sel[tid] = tid; nsel = N;
        __syncthreads();
    } else {
        unsigned prefix = 0u, mask = 0u; int need = 256;
        for (int pass = 0; pass < 4; ++pass) {
            const int shift = 24 - 8 * pass;
            hist[tid] = 0;
            __syncthreads();
            for (int s = tid; s < N; s += 256) { const unsigned k = keys[s]; if ((k & mask) == prefix) atomicAdd(&hist[(k >> shift) & 255], 1); }
            __syncthreads();
            if (tid == 0) {
                int cum = 0, bin = 255;
                for (; bin > 0; --bin) { if (cum + hist[bin] >= need) break; cum += hist[bin]; }
                sh_chosen = bin; sh_need = need - cum;
            }
            __syncthreads();
            prefix |= ((unsigned)sh_chosen) << shift; mask |= 0xFFu << shift; need = sh_need;
            __syncthreads();
        }
        const int chunk = (N + 255) / 256;
        const int s0 = tid * chunk, s1 = min(N, s0 + chunk);
        int c = 0;
        for (int s = s0; s < s1; ++s) c += (keys[s] == prefix) ? 1 : 0;
        cnt[tid] = c;
        __syncthreads();
        int before = 0;
        for (int i = 0; i < tid; ++i) before += cnt[i];
        for (int s = s0; s < s1; ++s) {
            const unsigned k = keys[s];
            bool take = false;
            if (k > prefix) take = true;
            else if (k == prefix) { if (before < need) take = true; ++before; }
            if (take) { const int p = atomicAdd(&sh_nsel, 1); if (p < 256) sel[p] = s; }
        }
        __syncthreads();
        nsel = min(sh_nsel, 256);
    }
    for (int p = tid; p < 8 * nsel; p += 256) {
        const int h = p / nsel, j = p - h * nsel;
        const float4* kp = (const float4*)(Kb + (size_t)(b * S + sel[j]) * 512 + h * 64);
        float d = 0.f;
#pragma unroll 4
        for (int e = 0; e < 16; ++e) { const float4 kk = kp[e]; d = fmaf(qv[h * 64 + e * 4], kk.x, d); d = fmaf(qv[h * 64 + e * 4 + 1], kk.y, d); d = fmaf(qv[h * 64 + e * 4 + 2], kk.z, d); d = fmaf(qv[h * 64 + e * 4 + 3], kk.w, d); }
        att[h * 256 + j] = d * 0.125f;
    }
    __syncthreads();
    {
        const int h = tid >> 5, l = tid & 31;
        float m = -INFINITY;
        for (int j = l; j < nsel; j += 32) m = fmaxf(m, att[h * 256 + j]);
        for (int o = 1; o < 32; o <<= 1) m = fmaxf(m, __shfl_xor(m, o, 32));
        float sum = 0.f;
        for (int j = l; j < nsel; j += 32) { const float e = expf(att[h * 256 + j] - m); att[h * 256 + j] = e; sum += e; }
        for (int o = 1; o < 32; o <<= 1) sum += __shfl_xor(sum, o, 32);
        const float inv = 1.0f / sum;
        for (int j = l; j < nsel; j += 32) att[h * 256 + j] *= inv;
    }
    __syncthreads();
    for (int o = tid; o < 512; o += 256) {
        const int h = o >> 6;
        float acc = 0.f;
#pragma unroll 4
        for (int j = 0; j < nsel; ++j) acc = fmaf(att[h * 256 + j], Vb[(size_t)(b * S + sel[j]) * 512 + o], acc);
        const float z = Zb[(size_t)tok * 512 + o];
        Zb[(size_t)tok * 512 + o] = acc * silu_f(z);
    }
}

__global__ void __launch_bounds__(256) gemm2_naive(const float* __restrict__ G, const float* __restrict__ Zb, const float* __restrict__ w, float* out) {
    __shared__ float As[16][68];
    __shared__ float Bs[16][68];
    const int tid = threadIdx.x, tx = tid & 15, ty = tid >> 4;
    const int n0 = blockIdx.x * 64, m0 = blockIdx.y * 64;
    float acc[4][4];
    for (int i = 0; i < 4; ++i) for (int j = 0; j < 4; ++j) acc[i][j] = 0.f;
    const int am = tid >> 2, ak = (tid & 3) * 4;
    const int bk = tid >> 4, bn = (tid & 15) * 4;
    for (int k0 = 0; k0 < D; k0 += 16) {
        const float* ap = (k0 < 512) ? (G + (size_t)(m0 + am) * 512 + k0 + ak) : (Zb + (size_t)(m0 + am) * 512 + (k0 - 512) + ak);
        float4 a = *(const float4*)ap;
        As[ak + 0][am] = a.x; As[ak + 1][am] = a.y; As[ak + 2][am] = a.z; As[ak + 3][am] = a.w;
        float4 bb = *(const float4*)(w + (size_t)(k0 + bk) * D + n0 + bn);
        Bs[bk][bn] = bb.x; Bs[bk][bn + 1] = bb.y; Bs[bk][bn + 2] = bb.z; Bs[bk][bn + 3] = bb.w;
        __syncthreads();
        for (int k = 0; k < 16; ++k) {
            float av[4], bv[4];
            for (int i = 0; i < 4; ++i) av[i] = As[k][ty * 4 + i];
            for (int j = 0; j < 4; ++j) bv[j] = Bs[k][tx * 4 + j];
            for (int i = 0; i < 4; ++i) for (int j = 0; j < 4; ++j) acc[i][j] = fmaf(av[i], bv[j], acc[i][j]);
        }
        __syncthreads();
    }
    for (int i = 0; i < 4; ++i) {
        const int m = m0 + ty * 4 + i;
        *(float4*)(out + (size_t)m * D + n0 + tx * 4) = make_float4(acc[i][0], acc[i][1], acc[i][2], acc[i][3]);
    }
}

__global__ void __launch_bounds__(256) final_kernel(const float* __restrict__ x, const float* __restrict__ g2, float* out) {
    const int row = blockIdx.x * 4 + (threadIdx.x >> 6), lane = threadIdx.x & 63;
    float4* yp = (float4*)(out + (size_t)row * D);
    const float4* xp = (const float4*)(x + (size_t)row * D);
    const float4* gp = (const float4*)g2;
    float4 v[4]; float s = 0.f;
    for (int j = 0; j < 4; ++j) { v[j] = yp[lane + 64 * j]; s += v[j].x * v[j].x + v[j].y * v[j].y + v[j].z * v[j].z + v[j].w * v[j].w; }
    for (int o = 1; o < 64; o <<= 1) s += __shfl_xor(s, o);
    const float r = 1.0f / sqrtf(s * (1.0f / D) + EPS);
    for (int j = 0; j < 4; ++j) {
        const float4 xx = xp[lane + 64 * j], gg = gp[lane + 64 * j];
        float4 o; o.x = xx.x + v[j].x * r * gg.x; o.y = xx.y + v[j].y * r * gg.y; o.z = xx.z + v[j].z * r * gg.z; o.w = xx.w + v[j].w * r * gg.w;
        yp[lane + 64 * j] = o;
    }
}

extern "C" void kernel_launch(void* const* d_in, const int* in_sizes, int n_in, void* d_out, int out_size, void* d_ws, size_t ws_size, hipStream_t stream) {
    const float* x = (const float*)d_in[0];
    const float* g1 = (const float*)d_in[1];
    const float* w_in = (const float*)d_in[2];
    const float* cw = (const float*)d_in[3];
    const float* w_out = (const float*)d_in[4];
    const float* g2 = (const float*)d_in[5];
    float* out = (float*)d_out;
    char* ws = (char*)d_ws;
    const size_t MB = 1u << 20;
    float* RS = (float*)(ws);
    float* U = (float*)(ws + 1 * MB);
    float* G = (float*)(ws + 33 * MB);
    float* Qb = (float*)(ws + 65 * MB);
    float* Kb = (float*)(ws + 97 * MB);
    float* Vb = (float*)(ws + 129 * MB);
    float* Zb = (float*)(ws + 161 * MB);
    float* QI = (float*)(ws + 193 * MB);
    float* KI = (float*)(ws + 209 * MB);
    float* Wb = (float*)(ws + 213 * MB);
    Rope rp;
    for (int j = 0; j < 8; ++j) rp.invf[j] = powf(500000.0f, -(float)j / 8.0f);
    rms_kernel<<<T / 4, 256, 0, stream>>>(x, RS);
    gemm1_naive<<<dim3((PROJ + 63) / 64, T / 64), 256, 0, stream>>>(x, RS, g1, w_in, U, G, Qb, Kb, Vb, Zb, QI, KI, Wb);
    rope_kernel<<<T, 256, 0, stream>>>(Qb, Kb, QI, KI, rp);
    conv_kernel<<<T * 512 / 256, 256, 0, stream>>>(U, G, cw);
    attn_naive<<<T, 256, 0, stream>>>(Qb, Kb, Vb, Zb, QI, KI, Wb);
    gemm2_naive<<<dim3(D / 64, T / 64), 256, 0, stream>>>(G, Zb, w_out, out);
    final_kernel<<<T / 4, 256, 0, stream>>>(x, g2, out);
}
```
